# Optimizing an MI355X kernel written in HIP

```python
import jax, jax.numpy as jnp
from jax import lax
import numpy as np

D_MODEL = 1024
BATCH = 2
SEQ = 8192
DEPTH = 1

GRID_W = 64
CTX_LEN = 256
NA_HEADS = 8
NA_HEAD_DIM = 64
NA_WIN_ROWS = 8
NA_WIN_COLS = 16
GLA_HEADS = 4
GLA_DK = 64
GLA_DV = 128
GLA_GATE_RANK = 16
GLA_GATE_TAU = 16.0
GLA_LOG_ALPHA_MIN = -1.0
GLA_CHUNK = 64
ROPE_THETA = 10000.0
D_FF = ((8 * D_MODEL + 3 * 256 - 1) // (3 * 256)) * 256
N_MOD = 6
NORM_EPS = 1e-6
NEG_INF = -1e30
NA_WIDTH = NA_HEADS * NA_HEAD_DIM
GLA_QK_WIDTH = GLA_HEADS * GLA_DK
GLA_V_WIDTH = GLA_HEADS * GLA_DV
IN_SPLITS = (NA_WIDTH, NA_WIDTH, NA_WIDTH, GLA_QK_WIDTH, GLA_QK_WIDTH, GLA_V_WIDTH, GLA_V_WIDTH,
             2 * GLA_GATE_RANK, D_MODEL, D_MODEL)
IN_OFFSETS = tuple(int(o) for o in np.cumsum(IN_SPLITS)[:-1])
D_IN = sum(IN_SPLITS)

kernel_name = "hybrid_na_gla_diffusion_block"


def rmsnorm(x, g):
    xf = x.astype(jnp.float32)
    y = xf * lax.rsqrt(jnp.mean(xf * xf, axis=-1, keepdims=True) + NORM_EPS)
    return (y * g.astype(jnp.float32)).astype(x.dtype)


def modulate(h, shift, scale):
    return h * (1 + scale) + shift


def heads(t, n):
    return t.reshape(*t.shape[:-1], n, -1)


def flip(t):
    return jnp.flip(t, axis=1)


def axial_rope(x, row_pos, col_pos):
    half = x.shape[-1] // 2
    n = half // 2
    freqs = ROPE_THETA ** (-jnp.arange(n, dtype=jnp.float32) / n)

    def rotate(xa, pos):
        ang = pos.astype(jnp.float32)[:, None] * freqs
        cos = jnp.cos(ang)[None, :, None, :]
        sin = jnp.sin(ang)[None, :, None, :]
        x1 = xa[..., :n].astype(jnp.float32)
        x2 = xa[..., n:].astype(jnp.float32)
        return jnp.concatenate([x1 * cos - x2 * sin, x1 * sin + x2 * cos], axis=-1)

    out = jnp.concatenate([rotate(x[..., :half], row_pos), rotate(x[..., half:], col_pos)], axis=-1)
    return out.astype(x.dtype)


def log_decay(z_lr, w_alpha, b_alpha):
    B, L, _ = z_lr.shape
    z = jnp.einsum('bldr,drk->bldk', z_lr.reshape(B, L, 2, GLA_GATE_RANK), w_alpha) + b_alpha
    la = jnp.maximum(jax.nn.log_sigmoid(z.astype(jnp.float32)) / GLA_GATE_TAU, GLA_LOG_ALPHA_MIN)
    la = la.reshape(B, L, 2, GLA_HEADS, GLA_DK)
    return la[:, :, 0], la[:, :, 1]


def gla_chunked(q, k, v, log_a, s0):
    B, L, H, dk = q.shape
    dv = v.shape[-1]
    n = L // GLA_CHUNK
    f32 = jnp.float32
    qc = q.astype(f32).reshape(B, n, GLA_CHUNK, H, dk)
    kc = k.astype(f32).reshape(B, n, GLA_CHUNK, H, dk)
    vc = v.astype(f32).reshape(B, n, GLA_CHUNK, H, dv)
    b = jnp.cumsum(log_a.astype(f32).reshape(B, n, GLA_CHUNK, H, dk), axis=2)
    b_last = b[:, :, -1:]
    q_dec = qc * jnp.exp(b)
    k_inv = kc * jnp.exp(-b)
    k_end = kc * jnp.exp(b_last - b)
    incl = jnp.tril(jnp.ones((GLA_CHUNK, GLA_CHUNK), dtype=bool))
    att = jnp.where(incl, jnp.einsum('bnihd,bnjhd->bnhij', q_dec, k_inv), 0.0)
    o_intra = jnp.einsum('bnhij,bnjhv->bnihv', att, vc)
    u = jnp.einsum('bnjhd,bnjhv->bnhdv', k_end, vc)
    decay = jnp.exp(b_last[:, :, 0])

    def step(s, inp):
        d_n, u_n = inp
        return d_n[..., None] * s + u_n, s

    _, s_prev = lax.scan(step, s0.astype(f32), (jnp.moveaxis(decay, 1, 0), jnp.moveaxis(u, 1, 0)))
    o_inter = jnp.einsum('bnihd,nbhdv->bnihv', q_dec, s_prev)
    return (o_intra + o_inter).reshape(B, L, H, dv)


def gla_final_state(k, v, log_a):
    b = jnp.cumsum(log_a.astype(jnp.float32), axis=1)
    w = jnp.exp(b[:, -1:] - b)
    return jnp.einsum('blhd,blhv->bhdv', k.astype(jnp.float32) * w, v.astype(jnp.float32))


def gla_bidir(q, k, v, la_f, la_b, s0_f, s0_b):
    o_f = gla_chunked(q, k, v, la_f, s0_f)
    o_b = flip(gla_chunked(flip(q), flip(k), flip(v), flip(la_b), s0_b))
    return o_f + o_b


def neighborhood_attention(q, k, v, k_ctx, v_ctx, rpb):
    B, L, H, Dh = q.shape
    rows = L // GRID_W
    kh = min(NA_WIN_ROWS, rows)
    kw = NA_WIN_COLS
    r = jnp.arange(rows)
    row_start = jnp.clip(r - kh // 2, 0, rows - kh)
    key_rows = row_start[:, None] + jnp.arange(kh)[None, :]
    cidx = jnp.arange(GRID_W)
    col_start = jnp.clip(cidx - kw // 2, 0, GRID_W - kw)
    in_win = (cidx[None, :] >= col_start[:, None]) & (cidx[None, :] < col_start[:, None] + kw)
    mask = jnp.broadcast_to(in_win[:, None, :], (GRID_W, kh, GRID_W)).reshape(GRID_W, kh * GRID_W)
    dr = key_rows - r[:, None]
    dc = jnp.clip(cidx[None, :] - cidx[:, None], -(kw - 1), kw - 1)
    bias = rpb.astype(jnp.float32)[:, dr[:, None, :, None] + NA_WIN_ROWS - 1,
                                   dc[None, :, None, :] + kw - 1]
    bias = bias.reshape(H, rows, GRID_W, kh * GRID_W)

    qg = q.reshape(B, rows, GRID_W, H, Dh)
    kb = k.reshape(B, rows, GRID_W, H, Dh)[:, key_rows].reshape(B, rows, kh * GRID_W, H, Dh)
    vb = v.reshape(B, rows, GRID_W, H, Dh)[:, key_rows].reshape(B, rows, kh * GRID_W, H, Dh)
    scale = NA_HEAD_DIM ** -0.5
    s_loc = jnp.einsum('brqhd,brkhd->bhrqk', qg, kb).astype(jnp.float32) * scale + bias
    s_loc = jnp.where(mask, s_loc, NEG_INF)
    s_ctx = jnp.einsum('brqhd,bkhd->bhrqk', qg, k_ctx).astype(jnp.float32) * scale
    p = jax.nn.softmax(jnp.concatenate([s_loc, s_ctx], axis=-1), axis=-1).astype(v.dtype)
    n_loc = kh * GRID_W
    o = (jnp.einsum('bhrqk,brkhd->brqhd', p[..., :n_loc], vb)
         + jnp.einsum('bhrqk,bkhd->brqhd', p[..., n_loc:], v_ctx))
    return o.reshape(B, L, H * Dh)


def context_attention(q, k, v):
    s = jnp.einsum('bqhd,bkhd->bhqk', q, k).astype(jnp.float32) * NA_HEAD_DIM ** -0.5
    p = jax.nn.softmax(s, axis=-1).astype(v.dtype)
    o = jnp.einsum('bhqk,bkhd->bqhd', p, v)
    return o.reshape(*o.shape[:2], -1)


def merge_branches(o_na, o_gla, og, m_a, m_b, gla_norm_g, w_br_na, w_br_gla, w_o):
    o_gla = rmsnorm(o_gla, gla_norm_g)
    o_gla = o_gla.reshape(*o_gla.shape[:2], -1).astype(og.dtype) * jax.nn.silu(og)
    y = jax.nn.sigmoid(m_a) * (o_na @ w_br_na) + jax.nn.sigmoid(m_b) * (o_gla @ w_br_gla)
    return y @ w_o


def swiglu(h, w_gate, w_up, w_down):
    return (jax.nn.silu(h @ w_gate) * (h @ w_up)) @ w_down


def setup_inputs(seed: int = 0) -> dict:
    key = jax.random.key(seed)
    ks = jax.random.split(key, 21)

    def nrm(k, shape, s):
        return jax.random.normal(k, shape, jnp.float32) * s

    L = DEPTH
    return {
        "x": nrm(ks[0], (BATCH, SEQ, D_MODEL), 1.0),
        "c": nrm(ks[1], (BATCH, D_MODEL), 1.0),
        "ctx": nrm(ks[2], (BATCH, CTX_LEN, D_MODEL), 1.0),
        "c_ctx": nrm(ks[3], (D_MODEL,), 1.0),
        "w_mod": nrm(ks[4], (L, D_MODEL, N_MOD * D_MODEL), 0.5 * D_MODEL ** -0.5),
        "b_mod": nrm(ks[5], (L, N_MOD * D_MODEL), 0.02),
        "norm1_g": 1.0 + nrm(ks[6], (L, D_MODEL), 0.05),
        "norm2_g": 1.0 + nrm(ks[7], (L, D_MODEL), 0.05),
        "w_in": nrm(ks[8], (L, D_MODEL, D_IN), D_MODEL ** -0.5),
        "na_q_norm_g": 1.0 + nrm(ks[9], (L, NA_HEAD_DIM), 0.05),
        "na_k_norm_g": 1.0 + nrm(ks[10], (L, NA_HEAD_DIM), 0.05),
        "na_rpb": nrm(ks[11], (L, NA_HEADS, 2 * NA_WIN_ROWS - 1, 2 * NA_WIN_COLS - 1), 0.5),
        "gla_w_alpha": nrm(ks[12], (L, 2, GLA_GATE_RANK, GLA_QK_WIDTH), GLA_GATE_RANK ** -0.5),
        "gla_b_alpha": 1.0 + nrm(ks[13], (L, 2, GLA_QK_WIDTH), 0.5),
        "gla_norm_g": 1.0 + nrm(ks[14], (L, GLA_DV), 0.05),
        "w_branch_na": nrm(ks[15], (L, NA_WIDTH, D_MODEL), NA_WIDTH ** -0.5),
        "w_branch_gla": nrm(ks[16], (L, GLA_V_WIDTH, D_MODEL), GLA_V_WIDTH ** -0.5),
        "w_out": nrm(ks[17], (L, D_MODEL, D_MODEL), D_MODEL ** -0.5),
        "w_ffn_gate": nrm(ks[18], (L, D_MODEL, D_FF), D_MODEL ** -0.5),
        "w_ffn_up": nrm(ks[19], (L, D_MODEL, D_FF), D_MODEL ** -0.5),
        "w_ffn_down": nrm(ks[20], (L, D_FF, D_MODEL), D_FF ** -0.5),
    }


def reference(x, c, ctx, c_ctx, w_mod, b_mod, norm1_g, norm2_g, w_in, na_q_norm_g, na_k_norm_g, na_rpb,
              gla_w_alpha, gla_b_alpha, gla_norm_g, w_branch_na, w_branch_gla, w_out,
              w_ffn_gate, w_ffn_up, w_ffn_down):
    B, L, _ = x.shape
    t = jnp.arange(L)
    row_pos, col_pos = t // GRID_W, t % GRID_W
    for layer in range(DEPTH):
        mod = jax.nn.silu(c) @ w_mod[layer] + b_mod[layer]
        mod_c = jax.nn.silu(c_ctx) @ w_mod[layer] + b_mod[layer]
        sh1, sc1, g1, sh2, sc2, g2 = jnp.split(mod[:, None, :], N_MOD, axis=-1)
        sh1c, sc1c, g1c, sh2c, sc2c, g2c = jnp.split(mod_c, N_MOD, axis=-1)
        (wq_na, wk_na, wv_na, wq_g, wk_g, wv_g, w_og, w_lr, w_ma, w_mb) = jnp.split(w_in[layer], IN_OFFSETS, axis=1)

        h = modulate(rmsnorm(x, norm1_g[layer]), sh1, sc1)
        hc = modulate(rmsnorm(ctx, norm1_g[layer]), sh1c, sc1c)

        k_na_c = rmsnorm(heads(hc @ wk_na, NA_HEADS), na_k_norm_g[layer])
        v_na_c = heads(hc @ wv_na, NA_HEADS)
        k_g_c = heads(hc @ wk_g, GLA_HEADS)
        v_g_c = heads(hc @ wv_g, GLA_HEADS)
        la_f_c, la_b_c = log_decay(hc @ w_lr, gla_w_alpha[layer], gla_b_alpha[layer])
        s_ctx_f = gla_final_state(k_g_c, v_g_c, la_f_c)
        s_ctx_b = gla_final_state(flip(k_g_c), flip(v_g_c), flip(la_b_c))

        (q_na, k_na, v_na, q_g, k_g, v_g, og, z_lr, m_a, m_b) = jnp.split(h @ w_in[layer], IN_OFFSETS, axis=-1)
        q_na = rmsnorm(heads(q_na, NA_HEADS), na_q_norm_g[layer])
        k_na = rmsnorm(heads(k_na, NA_HEADS), na_k_norm_g[layer])
        o_na = neighborhood_attention(q_na, k_na, heads(v_na, NA_HEADS), k_na_c, v_na_c, na_rpb[layer])
        q_g = axial_rope(heads(q_g, GLA_HEADS), row_pos, col_pos) * GLA_DK ** -0.5
        k_g = axial_rope(heads(k_g, GLA_HEADS), row_pos, col_pos)
        la_f, la_b = log_decay(z_lr, gla_w_alpha[layer], gla_b_alpha[layer])
        o_g = gla_bidir(q_g, k_g, heads(v_g, GLA_HEADS), la_f, la_b, s_ctx_f, s_ctx_b)
        mix = merge_branches(o_na, o_g, og, m_a, m_b, gla_norm_g[layer],
                             w_branch_na[layer], w_branch_gla[layer], w_out[layer])

        if layer + 1 < DEPTH:
            q_na_c = rmsnorm(heads(hc @ wq_na, NA_HEADS), na_q_norm_g[layer])
            o_na_c = context_attention(q_na_c, k_na_c, v_na_c)
            s_zero = jnp.zeros((B, GLA_HEADS, GLA_DK, GLA_DV), jnp.float32)
            q_g_c = heads(hc @ wq_g, GLA_HEADS) * GLA_DK ** -0.5
            o_g_c = gla_bidir(q_g_c, k_g_c, v_g_c, la_f_c, la_b_c, s_zero, s_zero)
            mix_c = merge_branches(o_na_c, o_g_c, hc @ w_og, hc @ w_ma, hc @ w_mb, gla_norm_g[layer],
                                   w_branch_na[layer], w_branch_gla[layer], w_out[layer])
            ctx = ctx + g1c * mix_c
            hc2 = modulate(rmsnorm(ctx, norm2_g[layer]), sh2c, sc2c)
            ctx = ctx + g2c * swiglu(hc2, w_ffn_gate[layer], w_ffn_up[layer], w_ffn_down[layer])

        x = x + g1 * mix
        h2 = modulate(rmsnorm(x, norm2_g[layer]), sh2, sc2)
        x = x + g2 * swiglu(h2, w_ffn_gate[layer], w_ffn_up[layer], w_ffn_down[layer])
    return x
```

```cpp
#include <hip/hip_runtime.h>
#include <cstdio>
#include <cstdint>

typedef unsigned short bf16_t;
__device__ __forceinline__ float bf2f(bf16_t v) { return __uint_as_float(((unsigned)v) << 16); }
__device__ __forceinline__ bf16_t f2bf(float f) { unsigned u = __float_as_uint(f); return (bf16_t)((u + 0x7fffu + ((u >> 16) & 1u)) >> 16); }

constexpr int BATCH = 2, SEQ = 8192, DM = 1024, M = BATCH * SEQ, CTX = 256, MC = BATCH * CTX, MT = M + MC;
constexpr int GRID_W = 64, ROWS = SEQ / GRID_W;
constexpr int NAH = 8, NAD = 64, GH = 4, GDK = 64, GDV = 128, RANK = 16;
constexpr int DFF = 2816, NMOD = 6;
constexpr int D_IN = 5152, NIN = 5376;
constexpr float EPS = 1e-6f;

constexpr int C_QN = 0, C_KN = 512, C_VN = 1024, C_QG = 1536, C_KG = 1792, C_VG = 2048, C_OG = 2560, C_MA = 3072, C_MB = 4096, C_ZL = 5120;

constexpr size_t MiB = 1u << 20;
constexpr size_t WS_WIN = 1 * MiB;
constexpr size_t WS_WBR = 12 * MiB;
constexpr size_t WS_WO = 14 * MiB;
constexpr size_t WS_WGU = 16 * MiB;
constexpr size_t WS_WD = 27 * MiB;
constexpr size_t WS_MISC = 33 * MiB;
constexpr size_t WS_H = 34 * MiB;
constexpr size_t WS_QN = 67 * MiB;
constexpr size_t WS_KN = 83 * MiB;
constexpr size_t WS_VN = 100 * MiB;
constexpr size_t WS_QG = 117 * MiB;
constexpr size_t WS_KG = 125 * MiB;
constexpr size_t WS_VG = 134 * MiB;
constexpr size_t WS_OG = 151 * MiB;
constexpr size_t WS_MA = 167 * MiB;
constexpr size_t WS_MB = 199 * MiB;
constexpr size_t WS_ZL = 231 * MiB;
constexpr size_t WS_Y = 67 * MiB;
constexpr size_t WS_ACT = 67 * MiB;
constexpr size_t WS_TMP = 160 * MiB;

__global__ void mod_kernel(const float* c, const float* c_ctx, const float* w_mod, const float* b_mod, float* MOD) {
    int j = blockIdx.x * blockDim.x + threadIdx.x; int r = blockIdx.y;
    if (j >= NMOD * DM) return;
    const float* src = r < 2 ? c + r * DM : c_ctx;
    float acc = 0.f;
    for (int k = 0; k < DM; ++k) { float v = src[k]; float s = v / (1.f + __expf(-v)); acc += s * w_mod[(size_t)k * (NMOD * DM) + j]; }
    MOD[r * NMOD * DM + j] = acc + b_mod[j];
}

__global__ void norm_mod_kernel(const float* x, const float* ctx, const float* g, const float* MOD, bf16_t* H, int which, int nrows) {
    int row = blockIdx.x; if (row >= nrows) return;
    const float* src; int mrow;
    if (row < M) { src = x + (size_t)row * DM; mrow = row / SEQ; } else { src = ctx + (size_t)(row - M) * DM; mrow = 2; }
    __shared__ float red[4];
    float v[4]; float s = 0.f;
    for (int i = 0; i < 4; ++i) { v[i] = src[threadIdx.x + 256 * i]; s += v[i] * v[i]; }
    for (int o = 32; o >= 1; o >>= 1) s += __shfl_xor(s, o);
    if ((threadIdx.x & 63) == 0) red[threadIdx.x >> 6] = s;
    __syncthreads();
    float tot = red[0] + red[1] + red[2] + red[3];
    float rinv = 1.0f / sqrtf(tot * (1.f / DM) + EPS);
    const float* sh = MOD + (size_t)mrow * NMOD * DM + (which ? 3 * DM : 0);
    const float* sc = sh + DM;
    for (int i = 0; i < 4; ++i) { int k = threadIdx.x + 256 * i; float y = v[i] * rinv * g[k]; H[(size_t)row * DM + k] = f2bf(y * (1.f + sc[k]) + sh[k]); }
}

__global__ void wconv_kernel(const float* W, int K, int N, int src_col0, int ncols, bf16_t* Wt, int dst_row0, int ldk, int koff) {
    int j = blockIdx.x * blockDim.x + threadIdx.x; int k = blockIdx.y;
    if (j >= ncols) return;
    Wt[(size_t)(dst_row0 + j) * ldk + koff + k] = f2bf(W[(size_t)k * N + src_col0 + j]);
}
__global__ void zero_rows_kernel(bf16_t* Wt, int row0, int nrows, int ldk) {
    size_t i = (size_t)blockIdx.x * blockDim.x + threadIdx.x; if (i >= (size_t)nrows * ldk) return;
    Wt[(size_t)row0 * ldk + i] = 0;
}

__global__ void gemm_naive(const bf16_t* A, int lda, const bf16_t* Bt, int ldb, float* C, int ldc, int Mr, int N, int K) {
    __shared__ float As[16][65], Bs[16][65];
    int tx = threadIdx.x & 15, ty = threadIdx.x >> 4;
    int m0 = blockIdx.y * 64, n0 = blockIdx.x * 64;
    float acc[4][4] = {};
    for (int k0 = 0; k0 < K; k0 += 16) {
        for (int i = threadIdx.x; i < 64 * 16; i += 256) { int r = i >> 4, kk = i & 15;
            As[kk][r] = (m0 + r < Mr) ? bf2f(A[(size_t)(m0 + r) * lda + k0 + kk]) : 0.f;
            Bs[kk][r] = (n0 + r < N) ? bf2f(Bt[(size_t)(n0 + r) * ldb + k0 + kk]) : 0.f; }
        __syncthreads();
#pragma unroll
        for (int kk = 0; kk < 16; ++kk) { float a[4], b[4];
#pragma unroll
            for (int i = 0; i < 4; ++i) { a[i] = As[kk][ty * 4 + i]; b[i] = Bs[kk][tx * 4 + i]; }
#pragma unroll
            for (int i = 0; i < 4; ++i)
#pragma unroll
                for (int j = 0; j < 4; ++j) acc[i][j] += a[i] * b[j]; }
        __syncthreads();
    }
    for (int i = 0; i < 4; ++i) for (int j = 0; j < 4; ++j) { int r = m0 + ty * 4 + i, c = n0 + tx * 4 + j; if (r < Mr && c < N) C[(size_t)r * ldc + c] = acc[i][j]; }
}

__global__ void post_inproj_kernel(const float* C, int row0, int nrows, const float* qg_, const float* kg_, unsigned char* ws) {
    int lr = blockIdx.x; if (lr >= nrows) return; int row = row0 + lr;
    const float* c = C + (size_t)lr * NIN;
    bool lat = row < M;
    bf16_t* QN = (bf16_t*)(ws + WS_QN); bf16_t* KN = (bf16_t*)(ws + WS_KN); bf16_t* VN = (bf16_t*)(ws + WS_VN);
    bf16_t* QG = (bf16_t*)(ws + WS_QG); bf16_t* KG = (bf16_t*)(ws + WS_KG); bf16_t* VG = (bf16_t*)(ws + WS_VG);
    bf16_t* OG = (bf16_t*)(ws + WS_OG); bf16_t* MA = (bf16_t*)(ws + WS_MA); bf16_t* MB = (bf16_t*)(ws + WS_MB); float* ZL = (float*)(ws + WS_ZL);
    int tid = threadIdx.x, lane = tid & 63;
    for (int i = 0; i < 4; ++i) { int col = i * 256 + tid; float v = c[col]; float s = v * v;
        for (int o = 32; o >= 1; o >>= 1) s += __shfl_xor(s, o);
        float rinv = 1.0f / sqrtf(s * (1.f / 64.f) + EPS);
        if (col < 512) { if (lat) QN[(size_t)row * 512 + col] = f2bf(v * rinv * qg_[lane]); }
        else KN[(size_t)row * 512 + (col - 512)] = f2bf(v * rinv * kg_[lane]); }
    for (int i = 0; i < 2; ++i) { int col = i * 256 + tid; VN[(size_t)row * 512 + col] = f2bf(c[C_VN + col]); VG[(size_t)row * 512 + col] = f2bf(c[C_VG + col]);
        if (lat) OG[(size_t)row * 512 + col] = f2bf(c[C_OG + col]); }
    if (lat) for (int i = 0; i < 4; ++i) { int col = i * 256 + tid; MA[(size_t)row * 1024 + col] = f2bf(c[C_MA + col]); MB[(size_t)row * 1024 + col] = f2bf(c[C_MB + col]); }
    if (tid < 32) ZL[(size_t)row * 32 + tid] = c[C_ZL + tid];
    { int col = tid; int hd = col & 63; float q = c[C_QG + col], k = c[C_KG + col];
      if (lat) { int t = row % SEQ; int pos = (hd < 32) ? (t / GRID_W) : (t % GRID_W); int i16 = hd & 15; bool second = (hd & 16) != 0;
          float freq = powf(10000.0f, -(float)i16 / 16.0f); float ang = (float)pos * freq;
          double red = (double)ang; red = red - 6.283185307179586 * rint(red / 6.283185307179586);
          float cs = cosf((float)red), sn = sinf((float)red);
          float qp = c[C_QG + (second ? col - 16 : col + 16)], kp = c[C_KG + (second ? col - 16 : col + 16)];
          float qo = second ? (qp * sn + q * cs) : (q * cs - qp * sn);
          float ko = second ? (kp * sn + k * cs) : (k * cs - kp * sn);
          QG[(size_t)row * 256 + col] = f2bf(qo * 0.125f); KG[(size_t)row * 256 + col] = f2bf(ko);
      } else KG[(size_t)row * 256 + col] = f2bf(k); }
}

__global__ void __launch_bounds__(128) na_naive(const unsigned char* ws, const float* rpb, bf16_t* OCAT) {
    int idx = blockIdx.x * blockDim.x + threadIdx.x; if (idx >= M * NAH) return;
    int h = idx % NAH; int tok = idx / NAH; int b = tok / SEQ, t = tok % SEQ; int r = t / GRID_W, cc = t % GRID_W;
    const bf16_t* QN = (const bf16_t*)(ws + WS_QN); const bf16_t* KN = (const bf16_t*)(ws + WS_KN); const bf16_t* VN = (const bf16_t*)(ws + WS_VN);
    float q[64]; for (int d = 0; d < 64; ++d) q[d] = bf2f(QN[(size_t)tok * 512 + h * 64 + d]);
    float o[64]; for (int d = 0; d < 64; ++d) o[d] = 0.f;
    float mx = -1e30f, l = 0.f;
    int rs = r - 4; rs = rs < 0 ? 0 : (rs > ROWS - 8 ? ROWS - 8 : rs);
    int cs = cc - 8; cs = cs < 0 ? 0 : (cs > GRID_W - 16 ? GRID_W - 16 : cs);
    for (int j = 0; j < 128 + CTX; ++j) {
        size_t krow; float bias = 0.f;
        if (j < 128) { int kr = rs + (j >> 4), kc = cs + (j & 15); krow = (size_t)b * SEQ + kr * GRID_W + kc;
            int dr = kr - r, dc = kc - cc; bias = rpb[(h * 15 + dr + 7) * 31 + dc + 15]; }
        else krow = (size_t)M + b * CTX + (j - 128);
        const bf16_t* kp = KN + krow * 512 + h * 64; float s = 0.f;
        for (int d = 0; d < 64; ++d) s += q[d] * bf2f(kp[d]);
        s = s * 0.125f + bias;
        float mn = fmaxf(mx, s); float f = __expf(mx - mn); float p = __expf(s - mn);
        l = l * f + p; const bf16_t* vp = VN + krow * 512 + h * 64;
        for (int d = 0; d < 64; ++d) o[d] = o[d] * f + p * bf2f(vp[d]);
        mx = mn;
    }
    float il = 1.f / l;
    for (int d = 0; d < 64; ++d) OCAT[(size_t)tok * 1024 + h * 64 + d] = f2bf(o[d] * il);
}

__global__ void __launch_bounds__(128) gla_naive(const unsigned char* ws, const float* w_alpha, const float* b_alpha, float* OUT  ) {
    int dir = blockIdx.x & 1, h = (blockIdx.x >> 1) & 3, b = blockIdx.x >> 3; int v = threadIdx.x;
    const bf16_t* QG = (const bf16_t*)(ws + WS_QG); const bf16_t* KG = (const bf16_t*)(ws + WS_KG); const bf16_t* VG = (const bf16_t*)(ws + WS_VG); const float* ZL = (const float*)(ws + WS_ZL);
    __shared__ float sq[64][64], sk[64][64], sd[64][64];
    float S[64]; for (int d = 0; d < 64; ++d) S[d] = 0.f;
    float* out = OUT + (size_t)dir * M * 512;
    const int nsteps = (CTX + SEQ) / 64;
    for (int cb = 0; cb < nsteps; ++cb) {
        bool isctx = cb < CTX / 64;
        __syncthreads();
        for (int i = threadIdx.x; i < 64 * 64; i += 128) { int p = i >> 6, d = i & 63;
            int tt = isctx ? (cb * 64 + p) : ((cb - CTX / 64) * 64 + p); int L = isctx ? CTX : SEQ; int t = dir ? (L - 1 - tt) : tt;
            size_t row = isctx ? ((size_t)M + b * CTX + t) : ((size_t)b * SEQ + t);
            sq[p][d] = isctx ? 0.f : bf2f(QG[row * 256 + h * 64 + d]);
            sk[p][d] = bf2f(KG[row * 256 + h * 64 + d]);
            float z = b_alpha[dir * 256 + h * 64 + d];
            for (int rr = 0; rr < RANK; ++rr) z += ZL[row * 32 + dir * 16 + rr] * w_alpha[(dir * RANK + rr) * 256 + h * 64 + d];
            float ls = fminf(z, 0.f) - log1pf(__expf(-fabsf(z)));
            float la = fmaxf(ls * (1.f / 16.f), -1.f);
            sd[p][d] = __expf(la); }
        __syncthreads();
        for (int p = 0; p < 64; ++p) {
            int tt = isctx ? (cb * 64 + p) : ((cb - CTX / 64) * 64 + p); int L = isctx ? CTX : SEQ; int t = dir ? (L - 1 - tt) : tt;
            size_t row = isctx ? ((size_t)M + b * CTX + t) : ((size_t)b * SEQ + t);
            float vv = bf2f(VG[row * 512 + h * 128 + v]); float o = 0.f;
#pragma unroll
            for (int d = 0; d < 64; ++d) { S[d] = sd[p][d] * S[d] + sk[p][d] * vv; o += S[d] * sq[p][d]; }
            if (!isctx) out[row * 512 + h * 128 + v] = o;
        }
    }
}

__global__ void gla_post(const float* OUT, const float* g, const unsigned char* ws, bf16_t* OCAT) {
    int row = blockIdx.x >> 2, h = blockIdx.x & 3; int v = threadIdx.x;
    const bf16_t* OG = (const bf16_t*)(ws + WS_OG);
    float o = OUT[(size_t)row * 512 + h * 128 + v] + OUT[(size_t)M * 512 + (size_t)row * 512 + h * 128 + v];
    float s = o * o; for (int k = 32; k >= 1; k >>= 1) s += __shfl_xor(s, k);
    __shared__ float red[2]; if ((v & 63) == 0) red[v >> 6] = s; __syncthreads();
    float rinv = 1.0f / sqrtf((red[0] + red[1]) * (1.f / 128.f) + EPS);
    float og = bf2f(OG[(size_t)row * 512 + h * 128 + v]); float sil = og / (1.f + __expf(-og));
    OCAT[(size_t)row * 1024 + 512 + h * 128 + v] = f2bf(o * rinv * g[v] * sil);
}

__global__ void merge_kernel(const float* C1, const float* C2, const bf16_t* MA, const bf16_t* MB, bf16_t* Y, size_t n) {
    size_t i = (size_t)blockIdx.x * blockDim.x + threadIdx.x; if (i >= n) return;
    float a = bf2f(MA[i]), b = bf2f(MB[i]);
    Y[i] = f2bf(C1[i] / (1.f + __expf(-a)) + C2[i] / (1.f + __expf(-b)));
}
__global__ void resid1_kernel(const float* x, float* out, const float* MOD) {
    size_t i = (size_t)blockIdx.x * blockDim.x + threadIdx.x; if (i >= (size_t)M * DM) return;
    int row = (int)(i / DM), k = (int)(i % DM); int b = row / SEQ;
    out[i] = x[i] + MOD[(size_t)b * NMOD * DM + 2 * DM + k] * out[i];
}
__global__ void swiglu_kernel(const float* C, bf16_t* ACT, int row0, int nrows) {
    size_t i = (size_t)blockIdx.x * blockDim.x + threadIdx.x; if (i >= (size_t)nrows * DFF) return;
    int lr = (int)(i / DFF), j = (int)(i % DFF);
    float gt = C[(size_t)lr * (2 * DFF) + j], up = C[(size_t)lr * (2 * DFF) + DFF + j];
    ACT[(size_t)(row0 + lr) * DFF + j] = f2bf(gt / (1.f + __expf(-gt)) * up);
}
__global__ void resid2_kernel(const float* C, float* out, const float* MOD, int row0, int nrows) {
    size_t i = (size_t)blockIdx.x * blockDim.x + threadIdx.x; if (i >= (size_t)nrows * DM) return;
    int lr = (int)(i / DM), k = (int)(i % DM); int row = row0 + lr; int b = row / SEQ;
    out[(size_t)row * DM + k] += MOD[(size_t)b * NMOD * DM + 5 * DM + k] * C[i];
}

extern "C" void kernel_launch(void* const* d_in, const int* in_sizes, int n_in, void* d_out, int out_size, void* d_ws, size_t ws_size, hipStream_t stream) {
    const float* x = (const float*)d_in[0]; const float* c = (const float*)d_in[1]; const float* ctx = (const float*)d_in[2]; const float* c_ctx = (const float*)d_in[3];
    const float* w_mod = (const float*)d_in[4]; const float* b_mod = (const float*)d_in[5]; const float* norm1_g = (const float*)d_in[6]; const float* norm2_g = (const float*)d_in[7];
    const float* w_in = (const float*)d_in[8]; const float* qng = (const float*)d_in[9]; const float* kng = (const float*)d_in[10]; const float* rpb = (const float*)d_in[11];
    const float* w_alpha = (const float*)d_in[12]; const float* b_alpha = (const float*)d_in[13]; const float* gla_g = (const float*)d_in[14];
    const float* w_bna = (const float*)d_in[15]; const float* w_bgla = (const float*)d_in[16]; const float* w_out = (const float*)d_in[17];
    const float* w_gate = (const float*)d_in[18]; const float* w_up = (const float*)d_in[19]; const float* w_down = (const float*)d_in[20];
    unsigned char* ws = (unsigned char*)d_ws; float* out = (float*)d_out;
    bf16_t* WIN = (bf16_t*)(ws + WS_WIN); bf16_t* WBR = (bf16_t*)(ws + WS_WBR); bf16_t* WO = (bf16_t*)(ws + WS_WO); bf16_t* WGU = (bf16_t*)(ws + WS_WGU); bf16_t* WD = (bf16_t*)(ws + WS_WD);
    float* MOD = (float*)(ws + WS_MISC); bf16_t* H = (bf16_t*)(ws + WS_H); bf16_t* OCAT = H; bf16_t* H2 = H;
    bf16_t* Y = (bf16_t*)(ws + WS_Y); bf16_t* ACT = (bf16_t*)(ws + WS_ACT); float* TMP = (float*)(ws + WS_TMP);

    auto conv = [&](const float* W, int K, int N, int src0, int nc, bf16_t* Wt, int dst0, int ldk, int koff) {
        hipLaunchKernelGGL(wconv_kernel, dim3((nc + 255) / 256, K), dim3(256), 0, stream, W, K, N, src0, nc, Wt, dst0, ldk, koff); };
    conv(w_in, DM, D_IN, 0, 3072, WIN, 0, DM, 0);
    conv(w_in, DM, D_IN, 3104, 2048, WIN, C_MA, DM, 0);
    conv(w_in, DM, D_IN, 3072, 32, WIN, C_ZL, DM, 0);
    hipLaunchKernelGGL(zero_rows_kernel, dim3((224 * DM + 255) / 256), dim3(256), 0, stream, WIN, 5152, 224, DM);
    conv(w_bna, 512, DM, 0, DM, WBR, 0, DM, 0);
    conv(w_bgla, 512, DM, 0, DM, WBR, 0, DM, 512);
    conv(w_out, DM, DM, 0, DM, WO, 0, DM, 0);
    conv(w_gate, DM, DFF, 0, DFF, WGU, 0, DM, 0);
    conv(w_up, DM, DFF, 0, DFF, WGU, DFF, DM, 0);
    conv(w_down, DFF, DM, 0, DM, WD, 0, DFF, 0);
    hipLaunchKernelGGL(mod_kernel, dim3(NMOD * DM / 256, 3), dim3(256), 0, stream, c, c_ctx, w_mod, b_mod, MOD);
    hipLaunchKernelGGL(norm_mod_kernel, dim3(MT), dim3(256), 0, stream, x, ctx, norm1_g, MOD, H, 0, MT);
    { const int CH = MT / 8;
      for (int ch = 0; ch < 8; ++ch) {
          hipLaunchKernelGGL(gemm_naive, dim3(NIN / 64, CH / 64), dim3(256), 0, stream, H + (size_t)ch * CH * DM, DM, WIN, DM, out, NIN, CH, NIN, DM);
          hipLaunchKernelGGL(post_inproj_kernel, dim3(CH), dim3(256), 0, stream, out, ch * CH, CH, qng, kng, ws); } }
    hipLaunchKernelGGL(na_naive, dim3(M * NAH / 128), dim3(128), 0, stream, ws, rpb, OCAT);
    hipLaunchKernelGGL(gla_naive, dim3(16), dim3(128), 0, stream, ws, w_alpha, b_alpha, out);
    hipLaunchKernelGGL(gla_post, dim3(M * 4), dim3(128), 0, stream, out, gla_g, ws, OCAT);
    { const int CH = M / 4; float* C1 = out; float* C2 = out + (size_t)CH * DM;
      for (int ch = 0; ch < 4; ++ch) {
          hipLaunchKernelGGL(gemm_naive, dim3(DM / 64, CH / 64), dim3(256), 0, stream, OCAT + (size_t)ch * CH * DM, DM, WBR, DM, C1, DM, CH, DM, 512);
          hipLaunchKernelGGL(gemm_naive, dim3(DM / 64, CH / 64), dim3(256), 0, stream, OCAT + (size_t)ch * CH * DM + 512, DM, WBR + 512, DM, C2, DM, CH, DM, 512);
          hipLaunchKernelGGL(merge_kernel, dim3((unsigned)(((size_t)CH * DM + 255) / 256)), dim3(256), 0, stream, C1, C2, (const bf16_t*)(ws + WS_MA) + (size_t)ch * CH * DM, (const bf16_t*)(ws + WS_MB) + (size_t)ch * CH * DM, Y + (size_t)ch * CH * DM, (size_t)CH * DM); } }
    hipLaunchKernelGGL(gemm_naive, dim3(DM / 64, M / 64), dim3(256), 0, stream, Y, DM, WO, DM, out, DM, M, DM, DM);
    hipLaunchKernelGGL(resid1_kernel, dim3((unsigned)(((size_t)M * DM + 255) / 256)), dim3(256), 0, stream, x, out, MOD);
    hipLaunchKernelGGL(norm_mod_kernel, dim3(M), dim3(256), 0, stream, (const float*)out, (const float*)nullptr, norm2_g, MOD, H2, 1, M);
    { const int CH = M / 8;
      for (int ch = 0; ch < 8; ++ch) {
          hipLaunchKernelGGL(gemm_naive, dim3(2 * DFF / 64, CH / 64), dim3(256), 0, stream, H2 + (size_t)ch * CH * DM, DM, WGU, DM, TMP, 2 * DFF, CH, 2 * DFF, DM);
          hipLaunchKernelGGL(swiglu_kernel, dim3((unsigned)(((size_t)CH * DFF + 255) / 256)), dim3(256), 0, stream, TMP, ACT, ch * CH, CH); } }
    { const int CH = M / 4;
      for (int ch = 0; ch < 4; ++ch) {
          hipLaunchKernelGGL(gemm_naive, dim3(DM / 64, CH / 64), dim3(256), 0, stream, ACT + (size_t)ch * CH * DFF, DFF, WD, DFF, TMP, DM, CH, DM, DFF);
          hipLaunchKernelGGL(resid2_kernel, dim3((unsigned)(((size_t)CH * DM + 255) / 256)), dim3(256), 0, stream, TMP, out, MOD, ch * CH, CH); } }
}
```
